# Optimizing an MI355X kernel written in HIP

```python
import jax, jax.numpy as jnp
from jax import lax
import numpy as np

D_MODEL = 1024
BATCH = 2
SEQ = 8192
DEPTH = 1

HEAD_DIM = 64
N_Q_HEADS = D_MODEL // HEAD_DIM
N_KV_HEADS = N_Q_HEADS // 8
GROUP = N_Q_HEADS // N_KV_HEADS
WINDOW = 128
BLOCK = 128
ATTN_WIDTH = N_Q_HEADS * HEAD_DIM
KV_WIDTH = N_KV_HEADS * HEAD_DIM
CONV_WIDTH = D_MODEL
CONV_K = 3
N_BRANCH = 2
D_FF = -(-8 * D_MODEL // (3 * 256)) * 256
IN_WIDTH = ATTN_WIDTH + 2 * KV_WIDTH + 3 * CONV_WIDTH + N_BRANCH * D_MODEL
N_MOD = 6
EPS = 1e-6

kernel_name = "hybrid_swa_sink_shortconv_gated_merge_adaln_block"


def rms_norm(x, g):
    xf = x.astype(jnp.float32)
    y = xf * lax.rsqrt(jnp.mean(xf * xf, axis=-1, keepdims=True) + EPS)
    return (y * g.astype(jnp.float32)).astype(x.dtype)


def with_prev_block(t):
    prev = jnp.pad(t, ((0, 0), (1, 0), (0, 0), (0, 0), (0, 0)))[:, :-1]
    return jnp.concatenate([prev, t], axis=2)


def sliding_window_sink_attention(q, k, v, sinks):
    B, T = q.shape[0], q.shape[1]
    nb = T // BLOCK
    qb = q.reshape(B, nb, BLOCK, N_KV_HEADS, GROUP, HEAD_DIM)
    kx = with_prev_block(k.reshape(B, nb, BLOCK, N_KV_HEADS, HEAD_DIM))
    vx = with_prev_block(v.reshape(B, nb, BLOCK, N_KV_HEADS, HEAD_DIM))
    s = jnp.einsum('bnqhgd,bnkhd->bnhgqk', qb, kx).astype(jnp.float32) * (HEAD_DIM ** -0.5)
    qpos = jnp.arange(BLOCK)[:, None] + BLOCK
    kpos = jnp.arange(2 * BLOCK)[None, :]
    rel = qpos - kpos
    band = (rel >= 0) & (rel < WINDOW)
    blk = jnp.arange(nb)[:, None, None]
    valid = band[None] & ((blk > 0) | (kpos[None] >= BLOCK))
    s = jnp.where(valid[None, :, None, None], s, -jnp.inf)
    sink = sinks.astype(jnp.float32).reshape(1, 1, N_KV_HEADS, GROUP, 1, 1)
    m = jnp.maximum(jnp.max(s, axis=-1, keepdims=True), sink)
    p = jnp.exp(s - m)
    denom = jnp.sum(p, axis=-1, keepdims=True) + jnp.exp(sink - m)
    p = (p / denom).astype(v.dtype)
    o = jnp.einsum('bnhgqk,bnkhd->bnqhgd', p, vx)
    return o.reshape(B, T, ATTN_WIDTH)


def causal_depthwise_conv(u, w):
    C = u.shape[-1]
    return lax.conv_general_dilated(
        u, w[:, None, :].astype(u.dtype), window_strides=(1,),
        padding=[(CONV_K - 1, 0)], dimension_numbers=('NWC', 'WIO', 'NWC'),
        feature_group_count=C)


def setup_inputs(seed: int = 0) -> dict:
    key = jax.random.key(seed)
    ks = jax.random.split(key, 16)
    f32 = jnp.float32
    nrm = lambda k, shape, s: jax.random.normal(k, shape, f32) * s
    return {
        "x": nrm(ks[0], (BATCH, SEQ, D_MODEL), 1.0),
        "c": nrm(ks[1], (BATCH, D_MODEL), 1.0),
        "w_ada": nrm(ks[2], (DEPTH, D_MODEL, N_MOD * D_MODEL), D_MODEL ** -0.5),
        "b_ada": nrm(ks[3], (DEPTH, N_MOD * D_MODEL), 0.02),
        "g_mix": 1.0 + nrm(ks[4], (DEPTH, D_MODEL), 0.02),
        "w_in": nrm(ks[5], (DEPTH, D_MODEL, IN_WIDTH), D_MODEL ** -0.5),
        "b_in": nrm(ks[6], (DEPTH, IN_WIDTH), 0.02),
        "sinks": nrm(ks[7], (DEPTH, N_Q_HEADS), 0.5),
        "conv_w": nrm(ks[8], (DEPTH, CONV_K, CONV_WIDTH), CONV_K ** -0.5),
        "w_out": nrm(ks[9], (DEPTH, D_MODEL, D_MODEL), D_MODEL ** -0.5),
        "g_ffn": 1.0 + nrm(ks[10], (DEPTH, D_MODEL), 0.02),
        "w_ffn_in": nrm(ks[11], (DEPTH, D_MODEL, 2 * D_FF), D_MODEL ** -0.5),
        "w_ffn_out": nrm(ks[12], (DEPTH, D_FF, D_MODEL), D_FF ** -0.5),
        "g_final": 1.0 + nrm(ks[13], (D_MODEL,), 0.02),
    }


def reference(x, c, w_ada, b_ada, g_mix, w_in, b_in, sinks, conv_w, w_out,
              g_ffn, w_ffn_in, w_ffn_out, g_final):
    splits = [ATTN_WIDTH,
              ATTN_WIDTH + KV_WIDTH,
              ATTN_WIDTH + 2 * KV_WIDTH,
              ATTN_WIDTH + 2 * KV_WIDTH + CONV_WIDTH,
              ATTN_WIDTH + 2 * KV_WIDTH + 2 * CONV_WIDTH,
              ATTN_WIDTH + 2 * KV_WIDTH + 3 * CONV_WIDTH,
              ATTN_WIDTH + 2 * KV_WIDTH + 3 * CONV_WIDTH + D_MODEL]
    for l in range(DEPTH):
        mod = (jax.nn.silu(c) @ w_ada[l] + b_ada[l])[:, None, :]
        sh1, sc1, ga1, sh2, sc2, ga2 = jnp.split(mod, N_MOD, axis=-1)

        h = rms_norm(x, g_mix[l]) * (1 + sc1) + sh1
        z = h @ w_in[l] + b_in[l]
        q, k, v, conv_b, conv_c, conv_x, gate_a, gate_c = jnp.split(z, splits, axis=-1)
        attn = sliding_window_sink_attention(q, k, v, sinks[l])
        conv = conv_b * causal_depthwise_conv(conv_c * conv_x, conv_w[l])
        merged = jax.nn.sigmoid(gate_a) * attn + jax.nn.sigmoid(gate_c) * conv
        x = x + ga1 * (merged @ w_out[l])

        h = rms_norm(x, g_ffn[l]) * (1 + sc2) + sh2
        gu = h @ w_ffn_in[l]
        g_part, u_part = jnp.split(gu, 2, axis=-1)
        x = x + ga2 * ((jax.nn.silu(g_part) * u_part) @ w_ffn_out[l])
    return rms_norm(x, g_final)
```

```cpp
#include <hip/hip_runtime.h>
#include <hip/hip_cooperative_groups.h>
#include <cstdio>
#include <cstdint>
namespace cg = cooperative_groups;
namespace pg8 {
#define PG8_LAS __attribute__((address_space(3)))
typedef unsigned short bf16_t;
typedef short bf16x8 __attribute__((ext_vector_type(8)));
typedef float f32x4 __attribute__((ext_vector_type(4)));
typedef unsigned u32x4 __attribute__((ext_vector_type(4)));
constexpr int BM = 256, BK = 64, HALF = 128, HTB = HALF * BK * 2  , STAGE_BYTES = 8 * HTB, NXCD = 8, WGM = 8;

__host__ __device__ __forceinline__ int lds_byte(int r, int c) { const int st = (r >> 4) * 2 + (c >> 5), rr = r & 15, cc = c & 31, ob = rr * 64 + cc * 2; return st * 1024 + (ob ^ (((ob >> 9) & 1) << 5)); }
__host__ __device__ __forceinline__ void stage_rc(int b, int& R, int& C) { const int st = b / 1024, sb = b % 1024, swz = sb ^ (((sb >> 9) & 1) << 5); R = (st >> 1) * 16 + swz / 64; C = (st & 1) * 32 + (swz % 64) / 2; }
__host__ __device__ __forceinline__ int perm32(int rho) { const int n = rho >> 4, i = rho & 15; return 8 * (i >> 2) + 4 * n + (i & 3); }

struct Unit { int pm, pn; };
struct Gemm { const bf16_t* A; const bf16_t* Bt; int M, N, K; };

struct StaticOrder {
    int nM, nN, nwg, G, c;
    __host__ __device__ void init(int M, int N, int G_, int c_) { nM = M / BM; nN = N / BM; nwg = nM * nN; G = G_; c = c_; }
    __host__ __device__ bool next(int i, Unit& u) const {
        const long L = (long)i * G + c; if (L >= nwg) return false;
        int wgid = (int)L; { const int q = nwg / NXCD, r = nwg % NXCD, xcd = wgid % NXCD, off = wgid / NXCD; wgid = (xcd < r ? xcd * (q + 1) : r * (q + 1) + (xcd - r) * q) + off; }
        const int nig = WGM * nN, gid = wgid / nig, fm = gid * WGM, gsz = (nM - fm) < WGM ? (nM - fm) : WGM;
        u.pm = fm + ((wgid % nig) % gsz); u.pn = (wgid % nig) / gsz; return true;
    }
    __device__ __forceinline__ void a_ready(const Unit&) const {}
    __device__ __forceinline__ void done(const Unit&) const {}
};

__device__ __forceinline__ unsigned cvt_pk_bf16(float lo, float hi) { unsigned r; asm volatile("v_cvt_pk_bf16_f32 %0, %1, %2" : "=v"(r) : "v"(lo), "v"(hi)); return r; }
typedef float f32x2 __attribute__((ext_vector_type(2)));
typedef unsigned u32x2 __attribute__((ext_vector_type(2)));
constexpr int E_SEQ = 8192, E_DM = 1024, E_NMOD = 6144, E_DFF = 2816, E_NFI = 5632, E_ZLD = 5376;
constexpr float E_EPS = 1e-6f;

struct EpiZ {
    static constexpr bool PERM = true, AFTER_DRAIN = false;
    bf16_t* Q; bf16_t* Z; const float* bias;
    __device__ __forceinline__ void operator()(const f32x4 (&acc)[2][2][4][2], const Unit& u, int wr, int wc, int fr, int fq) const {
        const int row0 = u.pm * BM + wr * 64 + fr; const int colt = u.pn * BM;
        bf16_t* base; int ldc;
        if (u.pn < 4) { base = Q + colt; ldc = E_DM; } else { base = Z + (colt - E_DM); ldc = E_ZLD; }
        const int col0 = wc * 32 + 8 * fq, bcol0 = colt + wc * 32 + 8 * fq;
        f32x4 bv[2][2];
#pragma unroll
        for (int bj = 0; bj < 2; ++bj)
#pragma unroll
            for (int n = 0; n < 2; ++n) bv[bj][n] = *(const f32x4*)(bias + bcol0 + bj * HALF + 4 * n);
#pragma unroll
        for (int ai = 0; ai < 2; ++ai)
#pragma unroll
            for (int m = 0; m < 4; ++m) { bf16_t* rowp = base + (size_t)(row0 + ai * HALF + m * 16) * ldc + col0;
#pragma unroll
                for (int bj = 0; bj < 2; ++bj) { const f32x4 v0 = acc[ai][bj][m][0] + bv[bj][0], v1 = acc[ai][bj][m][1] + bv[bj][1];
                    u32x4 w; w.x = cvt_pk_bf16(v0[0], v0[1]); w.y = cvt_pk_bf16(v0[2], v0[3]); w.z = cvt_pk_bf16(v1[0], v1[1]); w.w = cvt_pk_bf16(v1[2], v1[3]);
                    *(u32x4*)(rowp + bj * HALF) = w; } }
    }
};

template <bool WITH_XN> struct EpiRes {
    static constexpr bool PERM = false, AFTER_DRAIN = false;
    const float* xi; float* xo; const float* gate;
    float* ssq; bf16_t* xn; const float* gnorm; const float* scale;
    __device__ __forceinline__ void operator()(const f32x4 (&acc)[2][2][4][2], const Unit& u, int wr, int wc, int fr, int fq) const {
        const int b = (u.pm * BM) / E_SEQ;
        const int col0 = u.pn * BM + wc * 32 + 4 * fq;
        f32x4 ga[2][2], ge[2][2];
#pragma unroll
        for (int bj = 0; bj < 2; ++bj)
#pragma unroll
            for (int n = 0; n < 2; ++n) { const int c = col0 + bj * HALF + n * 16; ga[bj][n] = *(const f32x4*)(gate + b * E_NMOD + c);
                if (WITH_XN) { const f32x4 g = *(const f32x4*)(gnorm + c), s = *(const f32x4*)(scale + b * E_NMOD + c); ge[bj][n] = g * (s + 1.0f); } }
#pragma unroll
        for (int ai = 0; ai < 2; ++ai)
#pragma unroll
            for (int m = 0; m < 4; ++m) { const int r = u.pm * BM + ai * HALF + wr * 64 + m * 16 + fr; const size_t off = (size_t)r * E_DM + col0; float ss = 0.f;
#pragma unroll
                for (int bj = 0; bj < 2; ++bj)
#pragma unroll
                    for (int n = 0; n < 2; ++n) { const f32x4 xv = *(const f32x4*)(xi + off + bj * HALF + n * 16); const f32x4 v = xv + ga[bj][n] * acc[ai][bj][m][n];
                        *(f32x4*)(xo + off + bj * HALF + n * 16) = v; ss += (v[0] * v[0] + v[1] * v[1]) + (v[2] * v[2] + v[3] * v[3]);
                        if (WITH_XN) { const f32x4 a = v * ge[bj][n]; u32x2 w; w.x = cvt_pk_bf16(a[0], a[1]); w.y = cvt_pk_bf16(a[2], a[3]); *(u32x2*)(xn + off + bj * HALF + n * 16) = w; } }
                ss += __shfl_xor(ss, 16); ss += __shfl_xor(ss, 32);
                if (fq == 0) ssq[(size_t)r * 16 + u.pn * 4 + wc] = ss; }
    }
};

struct EpiSwi {
    static constexpr bool PERM = true, AFTER_DRAIN = false;
    bf16_t* H; const float* bias2; const float* ssq;
    __device__ __forceinline__ void operator()(const f32x4 (&acc)[2][2][4][2], const Unit& u, int wr, int wc, int fr, int fq) const {
        const int b = (u.pm * BM) / E_SEQ;
        const int bcol0 = u.pn * BM + wc * 32 + 8 * fq, hcol0 = u.pn * HALF + wc * 32 + 8 * fq;
        f32x4 bg[2], bu[2];
#pragma unroll
        for (int n = 0; n < 2; ++n) { bg[n] = *(const f32x4*)(bias2 + b * E_NFI + bcol0 + 4 * n); bu[n] = *(const f32x4*)(bias2 + b * E_NFI + bcol0 + HALF + 4 * n); }
#pragma unroll
        for (int ai = 0; ai < 2; ++ai)
#pragma unroll
            for (int m = 0; m < 4; ++m) { const int r = u.pm * BM + ai * HALF + wr * 64 + m * 16 + fr;
                const f32x4* sp = (const f32x4*)(ssq + (size_t)r * 16); const f32x4 s0 = sp[0], s1 = sp[1], s2 = sp[2], s3 = sp[3];
                const float tot = ((s0[0] + s0[1]) + (s0[2] + s0[3])) + ((s1[0] + s1[1]) + (s1[2] + s1[3])) + ((s2[0] + s2[1]) + (s2[2] + s2[3])) + ((s3[0] + s3[1]) + (s3[2] + s3[3]));
                const float rstd = __builtin_amdgcn_rsqf(tot * (1.0f / E_DM) + E_EPS);
                float hv[8];
#pragma unroll
                for (int n = 0; n < 2; ++n)
#pragma unroll
                    for (int e = 0; e < 4; ++e) { const float g = acc[ai][0][m][n][e] * rstd + bg[n][e], uu = acc[ai][1][m][n][e] * rstd + bu[n][e];
                        const float sg = g * __builtin_amdgcn_rcpf(1.0f + __builtin_amdgcn_exp2f(-1.4426950408889634f * g)); hv[4 * n + e] = sg * uu; }
                u32x4 w; w.x = cvt_pk_bf16(hv[0], hv[1]); w.y = cvt_pk_bf16(hv[2], hv[3]); w.z = cvt_pk_bf16(hv[4], hv[5]); w.w = cvt_pk_bf16(hv[6], hv[7]);
                *(u32x4*)(H + (size_t)r * E_DFF + hcol0) = w; }
    }
};

template <class Epi, class Sched, bool ALIGN_EPI = false, bool SP2 = false>
__device__ __forceinline__ void gemm_phase(PG8_LAS unsigned char* lds, const Gemm g, const Sched& S, const Epi& E) {
    const int tid = threadIdx.x, wid = __builtin_amdgcn_readfirstlane(tid >> 6), lane = tid & 63, wr = wid >> 2, wc = wid & 3, fr = lane & 15, fq = lane >> 4;
    const int K = g.K, nt = K / BK;
    unsigned voffA[2], voffB[2];
#pragma unroll
    for (int i = 0; i < 2; ++i) { int R, C; stage_rc(tid * 16 + i * 8192, R, C); const int Rb = Epi::PERM ? ((R & ~31) + perm32(R & 31)) : R;
        voffA[i] = (unsigned)(R * K + C) * 2u; voffB[i] = (unsigned)(Rb * K + C) * 2u; }
    const size_t kstep = (size_t)(BK * 2);
    const size_t hstep = (size_t)HALF * K * 2;
    const size_t tstep = 2 * hstep;
    const unsigned ldsw = (unsigned)wid * 1024u;
    const int aoff = lds_byte(wr * 64 + fr, fq * 8), boff = lds_byte(wc * 32 + fr, fq * 8);
#define PG8_SA(b, h) (((b) * 2 + (h)) * HTB)
#define PG8_SB(b, h) ((4 + (b) * 2 + (h)) * HTB)
#define PG8_STAGE(bufoff, gbase, voff) do { _Pragma("unroll") for (int _i = 0; _i < 2; ++_i) \
        __builtin_amdgcn_global_load_lds((const unsigned*)((const char*)(gbase) + (voff)[_i]), (PG8_LAS unsigned*)(lds + (bufoff) + ldsw + _i * 8192), 16, 0, 0); } while (0)
#define PG8_LDA(dst, b, h) do { _Pragma("unroll") for (int m = 0; m < 4; ++m) _Pragma("unroll") for (int k = 0; k < 2; ++k) dst[m][k] = *(const PG8_LAS bf16x8*)(lds + PG8_SA(b, h) + aoff + m * 2048 + k * 1024); } while (0)
#define PG8_LDB(dst, b, h) do { _Pragma("unroll") for (int n = 0; n < 2; ++n) _Pragma("unroll") for (int k = 0; k < 2; ++k) dst[n][k] = *(const PG8_LAS bf16x8*)(lds + PG8_SB(b, h) + boff + n * 2048 + k * 1024); } while (0)
#define PG8_MMA(ai, bj, At, Bt) do { __builtin_amdgcn_s_setprio(1); _Pragma("unroll") for (int m = 0; m < 4; ++m) _Pragma("unroll") for (int n = 0; n < 2; ++n) _Pragma("unroll") for (int k = 0; k < 2; ++k) \
        acc[ai][bj][m][n] = __builtin_amdgcn_mfma_f32_16x16x32_bf16(Bt[n][k], At[m][k], acc[ai][bj][m][n], 0, 0, 0); __builtin_amdgcn_s_setprio(0); } while (0)
#define PG8_WAIT_V(n) asm volatile("s_waitcnt vmcnt(" #n ")" ::: "memory")
#define PG8_WAIT_L(n) asm volatile("s_waitcnt lgkmcnt(" #n ")" ::: "memory")
#define PG8_BAR __builtin_amdgcn_s_barrier()
#define PG8_SCHED __builtin_amdgcn_sched_barrier(0)
    Unit cur, nxt; int ui = 0;
    if (!S.next(0, cur)) return;
    f32x4 acc[2][2][4][2];
#pragma unroll
    for (int a = 0; a < 2; ++a)
#pragma unroll
        for (int b = 0; b < 2; ++b)
#pragma unroll
            for (int m = 0; m < 4; ++m)
#pragma unroll
                for (int n = 0; n < 2; ++n) acc[a][b][m][n] = (f32x4){0.f, 0.f, 0.f, 0.f};
    bf16x8 At[4][2], B0[2][2], B1[2][2];
    const char* cA = (const char*)g.A + (size_t)cur.pm * tstep; const char* cB = (const char*)g.Bt + (size_t)cur.pn * tstep;
    S.a_ready(cur);
    if constexpr (SP2) {
        PG8_STAGE(PG8_SB(0, 0), cB, voffB); PG8_STAGE(PG8_SB(0, 1), cB + hstep, voffB); PG8_STAGE(PG8_SA(0, 0), cA, voffA); PG8_STAGE(PG8_SA(0, 1), cA + hstep, voffA);
        if (wr == 1) PG8_BAR;
        PG8_WAIT_V(2); PG8_BAR;
        PG8_STAGE(PG8_SB(1, 0), cB + kstep, voffB); PG8_STAGE(PG8_SA(1, 0), cA + kstep, voffA); PG8_STAGE(PG8_SB(1, 1), cB + hstep + kstep, voffB);
        PG8_WAIT_V(6); PG8_BAR;
    } else {
        PG8_STAGE(PG8_SB(0, 0), cB, voffB); PG8_STAGE(PG8_SA(0, 0), cA, voffA); PG8_STAGE(PG8_SB(0, 1), cB + hstep, voffB); PG8_STAGE(PG8_SA(0, 1), cA + hstep, voffA);
        if (wr == 1) PG8_BAR;
        PG8_WAIT_V(4); PG8_BAR;
        PG8_STAGE(PG8_SB(1, 0), cB + kstep, voffB); PG8_STAGE(PG8_SA(1, 0), cA + kstep, voffA); PG8_STAGE(PG8_SB(1, 1), cB + hstep + kstep, voffB);
        PG8_WAIT_V(6); PG8_BAR;
    }
    for (;;) {
        const bool has_next = S.next(ui + 1, nxt);
        const char* nA = has_next ? (const char*)g.A + (size_t)nxt.pm * tstep : cA; const char* nB = has_next ? (const char*)g.Bt + (size_t)nxt.pn * tstep : cB;
        for (int t = 0; t < nt; t += 2) {
            const bool last = (t == nt - 2);
            const char* a1 = cA + (size_t)(t + 1) * kstep;
            const char* a2 = last ? nA : cA + (size_t)(t + 2) * kstep; const char* b2 = last ? nB : cB + (size_t)(t + 2) * kstep;
            const char* a3 = a2 + kstep; const char* b3 = b2 + kstep;
            if (last && has_next) S.a_ready(nxt);
            if constexpr (SP2) {
            PG8_LDB(B0, 0, 0); PG8_LDB(B1, 0, 1); PG8_SCHED; PG8_LDA(At, 0, 0); PG8_STAGE(PG8_SA(1, 1), a1 + hstep, voffA);
            PG8_WAIT_V(8); PG8_WAIT_L(0); PG8_BAR; PG8_MMA(0, 0, At, B0); PG8_MMA(0, 1, At, B1); PG8_BAR; PG8_SCHED;
            PG8_LDA(At, 0, 1); PG8_STAGE(PG8_SB(0, 0), b2, voffB); PG8_STAGE(PG8_SB(0, 1), b2 + hstep, voffB); PG8_STAGE(PG8_SA(0, 0), a2, voffA);
            PG8_WAIT_V(8); PG8_WAIT_L(0); PG8_BAR; PG8_MMA(1, 0, At, B0); PG8_MMA(1, 1, At, B1); PG8_BAR; PG8_SCHED;
            PG8_LDB(B0, 1, 0); PG8_LDB(B1, 1, 1); PG8_SCHED; PG8_LDA(At, 1, 0); PG8_STAGE(PG8_SA(0, 1), a2 + hstep, voffA);
            PG8_WAIT_V(8); PG8_WAIT_L(0); PG8_BAR; PG8_MMA(0, 0, At, B0); PG8_MMA(0, 1, At, B1); PG8_BAR; PG8_SCHED;
            PG8_LDA(At, 1, 1); PG8_STAGE(PG8_SB(1, 0), b3, voffB); PG8_STAGE(PG8_SB(1, 1), b3 + hstep, voffB); PG8_STAGE(PG8_SA(1, 0), a3, voffA);
            PG8_WAIT_V(8); PG8_WAIT_L(0); PG8_BAR; PG8_MMA(1, 0, At, B0); PG8_MMA(1, 1, At, B1); PG8_BAR; PG8_SCHED;
            } else {
            PG8_LDB(B0, 0, 0); PG8_SCHED; PG8_LDA(At, 0, 0); PG8_STAGE(PG8_SA(1, 1), a1 + hstep, voffA);
            PG8_WAIT_L(8); PG8_BAR; PG8_WAIT_L(0); PG8_MMA(0, 0, At, B0); PG8_BAR; PG8_SCHED;
            PG8_LDB(B1, 0, 1); PG8_STAGE(PG8_SB(0, 0), b2, voffB);
            PG8_BAR; PG8_WAIT_L(0); PG8_MMA(0, 1, At, B1); PG8_BAR;
            PG8_LDA(At, 0, 1); PG8_STAGE(PG8_SA(0, 0), a2, voffA);
            PG8_BAR; PG8_WAIT_L(0); PG8_MMA(1, 0, At, B0); PG8_BAR; PG8_SCHED;
            PG8_STAGE(PG8_SB(0, 1), b2 + hstep, voffB);
            PG8_WAIT_V(6); PG8_BAR; PG8_MMA(1, 1, At, B1); PG8_BAR;
            PG8_LDB(B0, 1, 0); PG8_SCHED; PG8_LDA(At, 1, 0); PG8_STAGE(PG8_SA(0, 1), a2 + hstep, voffA);
            PG8_WAIT_L(8); PG8_BAR; PG8_WAIT_L(0); PG8_MMA(0, 0, At, B0); PG8_BAR; PG8_SCHED;
            PG8_LDB(B1, 1, 1); PG8_STAGE(PG8_SB(1, 0), b3, voffB);
            PG8_BAR; PG8_WAIT_L(0); PG8_MMA(0, 1, At, B1); PG8_BAR;
            PG8_LDA(At, 1, 1); PG8_STAGE(PG8_SA(1, 0), a3, voffA);
            PG8_BAR; PG8_WAIT_L(0); PG8_MMA(1, 0, At, B0); PG8_BAR; PG8_SCHED;
            PG8_STAGE(PG8_SB(1, 1), b3 + hstep, voffB);
            PG8_WAIT_V(6); PG8_BAR; PG8_MMA(1, 1, At, B1); PG8_BAR;
            }
        }
        if constexpr (ALIGN_EPI) { if (wr == 0) PG8_BAR; }
        if constexpr (!Epi::AFTER_DRAIN) { E(acc, cur, wr, wc, fr, fq); S.done(cur); }
        if (!has_next) break;
#pragma unroll
        for (int a = 0; a < 2; ++a)
#pragma unroll
            for (int b = 0; b < 2; ++b)
#pragma unroll
                for (int m = 0; m < 4; ++m)
#pragma unroll
                    for (int n = 0; n < 2; ++n) acc[a][b][m][n] = (f32x4){0.f, 0.f, 0.f, 0.f};
        cur = nxt; cA = nA; cB = nB; ++ui;
        if constexpr (ALIGN_EPI) { if (wr == 1) PG8_BAR; }
    }
    PG8_WAIT_V(0);
    if constexpr (!ALIGN_EPI) { if (wr == 0) PG8_BAR; }
    PG8_BAR;
    if constexpr (Epi::AFTER_DRAIN) { E.fused(acc, cur, wr, wc, fr, fq, lds, wid, lane); S.done(cur); }
#undef PG8_SA
#undef PG8_SB
#undef PG8_STAGE
#undef PG8_LDA
#undef PG8_LDB
#undef PG8_MMA
#undef PG8_WAIT_V
#undef PG8_WAIT_L
#undef PG8_BAR
#undef PG8_SCHED
}
}

constexpr int NWAVES = 8;
constexpr int BATCH = 2, SEQ = 8192, DM = 1024, M = BATCH * SEQ;
constexpr int NIN = 6400, DFF = 2816, NFI = 2 * DFF, NMOD = 6144, ZLD = 5376;
constexpr int ZC_K = 0, ZC_V = 128, ZC_CB = 256, ZC_CC = 1280, ZC_CX = 2304, ZC_GA = 3328, ZC_GC = 4352;
constexpr int MOD_SH1 = 0, MOD_SC1 = 1024, MOD_GA1 = 2048, MOD_SH2 = 3072, MOD_SC2 = 4096, MOD_GA2 = 5120;
constexpr float EPS = 1e-6f;
static_assert(pg8::E_ZLD == ZLD && pg8::E_NFI == NFI && pg8::E_DFF == DFF && pg8::E_NMOD == NMOD && pg8::E_DM == DM && pg8::E_SEQ == SEQ, "epilogue constants");

constexpr size_t MiB = 1u << 20;
constexpr size_t WS_MOD = 0;
constexpr size_t WS_BIAS2 = 64 * 1024;
constexpr size_t WS_SSQ1 = 1 * MiB, WS_SSQ2 = 2 * MiB;
constexpr size_t WS_WIN = 4 * MiB;
constexpr size_t WS_WOUT = 17 * MiB;
constexpr size_t WS_WFI = 19 * MiB;
constexpr size_t WS_WFO = 30 * MiB;
constexpr size_t WS_Z = 36 * MiB;
constexpr size_t WS_H = WS_Z;
constexpr size_t WS_XN2 = WS_Z + 96 * MiB;
constexpr size_t WS_MG = 204 * MiB;
constexpr size_t WS_END = 236 * MiB;

constexpr int RING_BYTES = 131072;
constexpr int LDS_SV = 131072, LDS_RED = 131072 + 8192;
constexpr int A_KS = 0, A_VT = 36864, A_OST = 70656;
constexpr int LDS_BYTES = 147456;
static_assert(A_OST + NWAVES * 8704 <= LDS_BYTES && LDS_RED + 4096 <= LDS_BYTES, "LDS map");

#define LAS __attribute__((address_space(3)))
typedef unsigned short bf16;
typedef unsigned v4u __attribute__((ext_vector_type(4)));
typedef float f32x4 __attribute__((ext_vector_type(4)));
typedef float f32x16 __attribute__((ext_vector_type(16)));
typedef short bf16x8 __attribute__((ext_vector_type(8)));

__device__ __forceinline__ unsigned f2bf(float f) { unsigned u = __builtin_bit_cast(unsigned, f); return (u + 0x7fffu + ((u >> 16) & 1u)) >> 16; }
__device__ __forceinline__ unsigned pk2(float lo, float hi) { return f2bf(lo) | (f2bf(hi) << 16); }
__device__ __forceinline__ float bflo(unsigned w) { return __builtin_bit_cast(float, w << 16); }
__device__ __forceinline__ float bfhi(unsigned w) { return __builtin_bit_cast(float, w & 0xffff0000u); }
__device__ __forceinline__ float sigmoidf_(float v) { return __builtin_amdgcn_rcpf(1.0f + __builtin_amdgcn_exp2f(-1.4426950408889634f * v)); }
__device__ __forceinline__ float wave_sum(float v) {
#pragma unroll
    for (int o = 1; o < 64; o <<= 1) v += __shfl_xor(v, o);
    return v;
}

__device__ __forceinline__ void transpose_item(const float* __restrict__ W, int K, int N, bf16* __restrict__ WT, int dest_row0, LAS float* scr, int k0, int n0, int lane) {
#pragma unroll 8
    for (int i = 0; i < 32; ++i) { const int kk = 2 * i + (lane >> 5); scr[kk * 33 + (lane & 31)] = W[(size_t)(k0 + kk) * N + n0 + (lane & 31)]; }
    asm volatile("s_waitcnt lgkmcnt(0)" ::: "memory");
    const int c = lane & 7;
#pragma unroll
    for (int j = 0; j < 4; ++j) { const int n = (lane >> 3) + 8 * j; const LAS float* s = scr + (8 * c) * 33 + n;
        v4u o; o.x = pk2(s[0 * 33], s[1 * 33]); o.y = pk2(s[2 * 33], s[3 * 33]); o.z = pk2(s[4 * 33], s[5 * 33]); o.w = pk2(s[6 * 33], s[7 * 33]);
        *(v4u*)(WT + (size_t)(dest_row0 + n) * K + k0 + 8 * c) = o; }
    asm volatile("s_waitcnt lgkmcnt(0)" ::: "memory");
}
__device__ __forceinline__ int ffi_dest(int n) { const int j = n < DFF ? n : n - DFF; return 256 * (j >> 7) + (n < DFF ? 0 : 128) + (j & 127); }

__device__ __forceinline__ float gemv64(const float* __restrict__ W, int N, int n0, const LAS float* sv, LAS float* red, int tid, int wave, int lane) {
    const float* wp = W + (size_t)(wave * 128) * N + n0 + lane;
    float a0 = 0.f, a1 = 0.f;
#pragma unroll 16
    for (int k = 0; k < 128; ++k) { const float w = wp[(size_t)k * N]; a0 += sv[wave * 128 + k] * w; a1 += sv[1024 + wave * 128 + k] * w; }
    red[(wave * 2 + 0) * 64 + lane] = a0; red[(wave * 2 + 1) * 64 + lane] = a1;
    __syncthreads();
    float s = 0.f;
    if (tid < 128) { const int b = tid >> 6;
#pragma unroll
        for (int w = 0; w < 8; ++w) s += red[(w * 2 + b) * 64 + lane]; }
    __syncthreads();
    return s;
}

__device__ __forceinline__ void attn_unit(int b, int nb, int kvh, const bf16* __restrict__ Qb, const bf16* __restrict__ Z, const float* __restrict__ sinks, const float* __restrict__ convw,
                                          bf16* __restrict__ MG, LAS unsigned char* lds, int tid, int wid, int lane) {
    const int l31 = lane & 31, hi = lane >> 5;
    const size_t rowbase = (size_t)b * SEQ; const int t0 = nb * 128;
#pragma unroll
    for (int i = 0; i < 4; ++i) {
        const int c = tid + 512 * i, key = c >> 3, part = c & 7, t = t0 - 128 + key;
        v4u kv = {0u, 0u, 0u, 0u}, vv = {0u, 0u, 0u, 0u};
        if (t >= 0) { const bf16* zr = Z + (rowbase + t) * ZLD + kvh * 64 + part * 8; kv = *(const v4u*)(zr + ZC_K); vv = *(const v4u*)(zr + ZC_V); }
        *(LAS v4u*)(lds + A_KS + key * 144 + part * 16) = kv;
        LAS unsigned short* vt = (LAS unsigned short*)(lds + A_VT + (part * 8) * 528 + key * 2);
        vt[0 * 264] = (unsigned short)(vv.x & 0xffffu); vt[1 * 264] = (unsigned short)(vv.x >> 16);
        vt[2 * 264] = (unsigned short)(vv.y & 0xffffu); vt[3 * 264] = (unsigned short)(vv.y >> 16);
        vt[4 * 264] = (unsigned short)(vv.z & 0xffffu); vt[5 * 264] = (unsigned short)(vv.z >> 16);
        vt[6 * 264] = (unsigned short)(vv.w & 0xffffu); vt[7 * 264] = (unsigned short)(vv.w >> 16);
    }
    __syncthreads();
    const int h = kvh * 8 + wid;
    const float LOG2E = 1.4426950408889634f, C2 = 0.125f * LOG2E;
    const float sink2 = sinks[h] * LOG2E;
    const int ch = h * 64 + (lane & 7) * 8;
    float cw0[8], cw1[8], cw2[8];
#pragma unroll
    for (int e = 0; e < 8; ++e) { cw0[e] = convw[ch + e]; cw1[e] = convw[DM + ch + e]; cw2[e] = convw[2 * DM + ch + e]; }
    const int kap = (l31 & ~12) | ((l31 & 4) << 1) | ((l31 & 8) >> 1);
    const LAS unsigned char* kbase = lds + A_KS + kap * 144 + hi * 16;
    const LAS unsigned char* vbase = lds + A_VT + l31 * 528 + hi * 16;
    LAS float* ost = (LAS float*)(lds + A_OST + wid * 8704);
    const bool nb0 = (nb == 0);
#pragma unroll 1
    for (int qs = 0; qs < 4; ++qs) {
        const bf16* qrow = Qb + (rowbase + t0 + 32 * qs + l31) * DM + h * 64 + hi * 8;
        bf16x8 qr[4];
#pragma unroll
        for (int d0 = 0; d0 < 4; ++d0) qr[d0] = *(const bf16x8*)(qrow + 16 * d0);
        f32x16 s[5];
#pragma unroll
        for (int kt = 0; kt < 5; ++kt) {
            const LAS unsigned char* kp = kbase + (32 * (qs + kt)) * 144;
            f32x16 a = {0.f, 0.f, 0.f, 0.f, 0.f, 0.f, 0.f, 0.f, 0.f, 0.f, 0.f, 0.f, 0.f, 0.f, 0.f, 0.f};
#pragma unroll
            for (int d0 = 0; d0 < 4; ++d0) a = __builtin_amdgcn_mfma_f32_32x32x16_bf16(*(const LAS bf16x8*)(kp + d0 * 32), qr[d0], a, 0, 0, 0);
            s[kt] = a;
        }
        float mx = sink2;
#pragma unroll
        for (int kt = 0; kt < 5; ++kt) {
            const bool tile_ok = !nb0 || (qs + kt >= 4);
#pragma unroll
            for (int r = 0; r < 16; ++r) {
                const int kk = (r & 7) + 8 * hi + 16 * (r >> 3);
                bool valid = tile_ok;
                if (kt == 0) valid = valid && (kk > l31);
                if (kt == 4) valid = valid && (kk <= l31);
                const float v = valid ? s[kt][r] * C2 : -INFINITY;
                s[kt][r] = v; mx = fmaxf(mx, v);
            }
        }
        mx = fmaxf(mx, __shfl_xor(mx, 32));
        float sum = 0.f;
#pragma unroll
        for (int kt = 0; kt < 5; ++kt)
#pragma unroll
            for (int r = 0; r < 16; ++r) { const float p = __builtin_amdgcn_exp2f(s[kt][r] - mx); s[kt][r] = p; sum += p; }
        sum += __shfl_xor(sum, 32);
        const float inv = 1.0f / (sum + __builtin_amdgcn_exp2f(sink2 - mx));
        f32x16 o0 = {0.f, 0.f, 0.f, 0.f, 0.f, 0.f, 0.f, 0.f, 0.f, 0.f, 0.f, 0.f, 0.f, 0.f, 0.f, 0.f}, o1 = o0;
#pragma unroll
        for (int kt = 0; kt < 5; ++kt)
#pragma unroll
            for (int ss = 0; ss < 2; ++ss) {
                v4u pw; pw.x = pg8::cvt_pk_bf16(s[kt][8 * ss + 0], s[kt][8 * ss + 1]); pw.y = pg8::cvt_pk_bf16(s[kt][8 * ss + 2], s[kt][8 * ss + 3]);
                pw.z = pg8::cvt_pk_bf16(s[kt][8 * ss + 4], s[kt][8 * ss + 5]); pw.w = pg8::cvt_pk_bf16(s[kt][8 * ss + 6], s[kt][8 * ss + 7]);
                const bf16x8 pf = __builtin_bit_cast(bf16x8, pw);
                const LAS unsigned char* vp = vbase + (32 * (qs + kt) + 16 * ss) * 2;
                o0 = __builtin_amdgcn_mfma_f32_32x32x16_bf16(*(const LAS bf16x8*)(vp), pf, o0, 0, 0, 0);
                o1 = __builtin_amdgcn_mfma_f32_32x32x16_bf16(*(const LAS bf16x8*)(vp + 32 * 528), pf, o1, 0, 0, 0);
            }
#pragma unroll
        for (int g = 0; g < 4; ++g) {
            *(LAS f32x4*)(ost + l31 * 68 + 8 * g + 4 * hi) = (f32x4){o0[4 * g + 0] * inv, o0[4 * g + 1] * inv, o0[4 * g + 2] * inv, o0[4 * g + 3] * inv};
            *(LAS f32x4*)(ost + l31 * 68 + 32 + 8 * g + 4 * hi) = (f32x4){o1[4 * g + 0] * inv, o1[4 * g + 1] * inv, o1[4 * g + 2] * inv, o1[4 * g + 3] * inv};
        }
#pragma unroll
        for (int i = 0; i < 4; ++i) {
            const int row = (lane >> 3) + 8 * i, t = t0 + 32 * qs + row;
            const f32x4 oa = *(const LAS f32x4*)(ost + row * 68 + (lane & 7) * 8), ob = *(const LAS f32x4*)(ost + row * 68 + (lane & 7) * 8 + 4);
            const bf16* zr = Z + (rowbase + t) * ZLD + ch;
            const v4u ga = *(const v4u*)(zr + ZC_GA), gc = *(const v4u*)(zr + ZC_GC), cb = *(const v4u*)(zr + ZC_CB);
            const v4u c0 = *(const v4u*)(zr + ZC_CC), x0 = *(const v4u*)(zr + ZC_CX);
            v4u c1 = {0u, 0u, 0u, 0u}, x1 = c1, c2 = c1, x2 = c1;
            if (t >= 1) { c1 = *(const v4u*)(zr - ZLD + ZC_CC); x1 = *(const v4u*)(zr - ZLD + ZC_CX); }
            if (t >= 2) { c2 = *(const v4u*)(zr - 2 * ZLD + ZC_CC); x2 = *(const v4u*)(zr - 2 * ZLD + ZC_CX); }
            float mg[8];
#pragma unroll
            for (int e = 0; e < 8; ++e) {
                const int w = e >> 1; const bool up = (e & 1);
                const float fga = up ? bfhi(ga[w]) : bflo(ga[w]), fgc = up ? bfhi(gc[w]) : bflo(gc[w]), fcb = up ? bfhi(cb[w]) : bflo(cb[w]);
                const float u0 = (up ? bfhi(c0[w]) : bflo(c0[w])) * (up ? bfhi(x0[w]) : bflo(x0[w]));
                const float u1 = (up ? bfhi(c1[w]) : bflo(c1[w])) * (up ? bfhi(x1[w]) : bflo(x1[w]));
                const float u2 = (up ? bfhi(c2[w]) : bflo(c2[w])) * (up ? bfhi(x2[w]) : bflo(x2[w]));
                const float conv = cw0[e] * u2 + cw1[e] * u1 + cw2[e] * u0;
                const float att = (e < 4) ? oa[e & 3] : ob[e & 3];
                mg[e] = sigmoidf_(fga) * att + sigmoidf_(fgc) * fcb * conv;
            }
            v4u o; o.x = pg8::cvt_pk_bf16(mg[0], mg[1]); o.y = pg8::cvt_pk_bf16(mg[2], mg[3]); o.z = pg8::cvt_pk_bf16(mg[4], mg[5]); o.w = pg8::cvt_pk_bf16(mg[6], mg[7]);
            *(v4u*)(MG + (rowbase + t) * DM + ch) = o;
        }
    }
    __syncthreads();
}

struct Args { const float* in[14]; float* out; unsigned char* ws; };
__global__ void __launch_bounds__(NWAVES * 64, 2) fwd_megakernel(Args args) {
    extern __shared__ __attribute__((aligned(16))) unsigned char lds_raw[];
    cg::grid_group grid = cg::this_grid();
    LAS unsigned char* lds = (LAS unsigned char*)lds_raw;
    const int tid = threadIdx.x, lane = tid & 63, wave = __builtin_amdgcn_readfirstlane(tid >> 6);
    const int G = gridDim.x, bx = blockIdx.x;
    const int vcu = (G % 8 == 0) ? (bx % 8) * (G / 8) + bx / 8 : bx;
    const int gw = vcu * NWAVES + wave, NGW = G * NWAVES;
    const float* x = args.in[0]; const float* cvec = args.in[1]; const float* w_ada = args.in[2]; const float* b_ada = args.in[3]; const float* g_mix = args.in[4];
    const float* w_in = args.in[5]; const float* b_in = args.in[6]; const float* sinks = args.in[7]; const float* conv_w = args.in[8]; const float* w_out = args.in[9];
    const float* g_ffn = args.in[10]; const float* w_ffn_in = args.in[11]; const float* w_ffn_out = args.in[12]; const float* g_final = args.in[13];
    float* out = args.out; unsigned char* ws = args.ws;
    float* mod = (float*)(ws + WS_MOD); float* bias2 = (float*)(ws + WS_BIAS2); float* ssq1 = (float*)(ws + WS_SSQ1); float* ssq2 = (float*)(ws + WS_SSQ2);
    bf16* Win_t = (bf16*)(ws + WS_WIN); bf16* Wout_t = (bf16*)(ws + WS_WOUT); bf16* Wfi_t = (bf16*)(ws + WS_WFI); bf16* Wfo_t = (bf16*)(ws + WS_WFO);
    bf16* Zb = (bf16*)(ws + WS_Z); bf16* Hb = (bf16*)(ws + WS_H); bf16* XN2 = (bf16*)(ws + WS_XN2); bf16* MG = (bf16*)(ws + WS_MG);
    bf16* XN = (bf16*)out; bf16* Qb = (bf16*)out + (size_t)M * DM;
    LAS float* sv = (LAS float*)(lds + LDS_SV); LAS float* red = (LAS float*)(lds + LDS_RED);

    {
        for (int i = tid; i < 2 * DM; i += NWAVES * 64) { const float cv = cvec[i]; sv[i] = cv * sigmoidf_(cv); }
        __syncthreads();
        for (int item = bx; item < NMOD / 64; item += G) {
            const int n0 = item * 64; const float s = gemv64(w_ada, NMOD, n0, sv, red, tid, wave, lane);
            if (tid < 128) mod[(tid >> 6) * NMOD + n0 + lane] = s + b_ada[n0 + lane];
        }
        LAS float* scr = (LAS float*)(lds + wave * 16384);
        constexpr int I_IN = 16 * (NIN / 32), I_OUT = 16 * (DM / 32), I_FI = 16 * (NFI / 32), I_FO = (DFF / 64) * (DM / 32);
        for (int it = gw; it < I_IN + I_OUT + I_FI + I_FO; it += NGW) {
            int r = it;
            if (r < I_IN) { const int nblk = NIN / 32, kb = r / nblk, nbk = r % nblk; transpose_item(w_in, DM, NIN, Win_t, 32 * nbk, scr, 64 * kb, 32 * nbk, lane); continue; } r -= I_IN;
            if (r < I_OUT) { const int nblk = DM / 32, kb = r / nblk, nbk = r % nblk; transpose_item(w_out, DM, DM, Wout_t, 32 * nbk, scr, 64 * kb, 32 * nbk, lane); continue; } r -= I_OUT;
            if (r < I_FI) { const int nblk = NFI / 32, kb = r / nblk, nbk = r % nblk; transpose_item(w_ffn_in, DM, NFI, Wfi_t, ffi_dest(32 * nbk), scr, 64 * kb, 32 * nbk, lane); continue; } r -= I_FI;
            { const int nblk = DM / 32, kb = r / nblk, nbk = r % nblk; transpose_item(w_ffn_out, DFF, DM, Wfo_t, 32 * nbk, scr, 64 * kb, 32 * nbk, lane); }
        }
    }
    grid.sync();
    {
        for (int i = tid; i < 2 * DM; i += NWAVES * 64) sv[i] = mod[(i >> 10) * NMOD + MOD_SH2 + (i & 1023)];
        __syncthreads();
        for (int item = bx; item < NFI / 64; item += G) {
            const int n0 = item * 64; const float s = gemv64(w_ffn_in, NFI, n0, sv, red, tid, wave, lane);
            if (tid < 128) bias2[(tid >> 6) * NFI + ffi_dest(n0 + lane)] = s;
        }
        for (int m = gw; m < M; m += NGW) {
            const int b = m / SEQ; const f32x4* xr = (const f32x4*)(x + (size_t)m * DM) + lane;
            f32x4 v[4]; float s = 0.f;
#pragma unroll
            for (int j = 0; j < 4; ++j) { v[j] = xr[64 * j]; s += (v[j].x * v[j].x + v[j].y * v[j].y) + (v[j].z * v[j].z + v[j].w * v[j].w); }
            const float rstd = 1.0f / sqrtf(wave_sum(s) * (1.0f / DM) + EPS);
            unsigned long long* o8 = (unsigned long long*)(XN + (size_t)m * DM) + lane;
#pragma unroll
            for (int j = 0; j < 4; ++j) { const int c = 4 * lane + 256 * j;
                const f32x4 g = *(const f32x4*)(g_mix + c), sc = *(const f32x4*)(mod + b * NMOD + MOD_SC1 + c), sh = *(const f32x4*)(mod + b * NMOD + MOD_SH1 + c);
                const f32x4 y = v[j] * rstd * g * (sc + 1.0f) + sh;
                o8[64 * j] = (unsigned long long)pk2(y.x, y.y) | ((unsigned long long)pk2(y.z, y.w) << 32); }
        }
    }
    grid.sync();
    {
        pg8::Gemm g{XN, Win_t, M, NIN, DM}; pg8::StaticOrder S; S.init(M, NIN, G, bx);
        pg8::EpiZ E{Qb, Zb, b_in};
        pg8::gemm_phase<pg8::EpiZ, pg8::StaticOrder, true, true>(lds, g, S, E);
    }
    grid.sync();
    for (int u = bx; u < BATCH * (SEQ / 128) * 2; u += G) attn_unit(u >> 7, (u >> 1) & 63, u & 1, Qb, Zb, sinks, conv_w, MG, lds, tid, wave, lane);
    grid.sync();
    {
        pg8::Gemm g{MG, Wout_t, M, DM, DM}; pg8::StaticOrder S; S.init(M, DM, G, bx);
        pg8::EpiRes<true> E{x, out, mod + MOD_GA1, ssq1, XN2, g_ffn, mod + MOD_SC2};
        pg8::gemm_phase<pg8::EpiRes<true>, pg8::StaticOrder, true, true>(lds, g, S, E);
    }
    grid.sync();
    {
        pg8::Gemm g{XN2, Wfi_t, M, NFI, DM}; pg8::StaticOrder S; S.init(M, NFI, G, bx);
        pg8::EpiSwi E{Hb, bias2, ssq1};
        pg8::gemm_phase<pg8::EpiSwi, pg8::StaticOrder, true, true>(lds, g, S, E);
    }
    grid.sync();
    {
        pg8::Gemm g{Hb, Wfo_t, M, DM, DFF}; pg8::StaticOrder S; S.init(M, DM, G, bx);
        pg8::EpiRes<false> E{out, out, mod + MOD_GA2, ssq2, nullptr, nullptr, nullptr};
        pg8::gemm_phase<pg8::EpiRes<false>, pg8::StaticOrder, true, true>(lds, g, S, E);
    }
    grid.sync();
    for (int m = gw; m < M; m += NGW) {
        const float sq = (lane < 16) ? ssq2[(size_t)m * 16 + lane] : 0.f;
        const float rstd = 1.0f / sqrtf(wave_sum(sq) * (1.0f / DM) + EPS);
        f32x4* xr = (f32x4*)(out + (size_t)m * DM) + lane;
#pragma unroll
        for (int j = 0; j < 4; ++j) { const f32x4 g = *(const f32x4*)(g_final + 4 * lane + 256 * j); xr[64 * j] = xr[64 * j] * rstd * g; }
    }
}

extern "C" void kernel_launch(void* const* d_in, const int* in_sizes, int n_in, void* d_out, int out_size, void* d_ws, size_t ws_size, hipStream_t stream) {
    static int grid = 0;
    if (grid == 0) {
        if (n_in != 14 || out_size != M * DM || ws_size < WS_END) { fprintf(stderr, "kernel_launch: unexpected shapes (n_in %d, out %d, ws %zu)\n", n_in, out_size, ws_size); grid = -1; return; }
        int dev = 0, cus = 0, per_cu = 0;
        if (hipGetDevice(&dev) != hipSuccess || hipDeviceGetAttribute(&cus, hipDeviceAttributeMultiprocessorCount, dev) != hipSuccess) { grid = -1; return; }
        if (hipFuncSetAttribute((const void*)fwd_megakernel, hipFuncAttributeMaxDynamicSharedMemorySize, LDS_BYTES) != hipSuccess) { fprintf(stderr, "kernel_launch: hipFuncSetAttribute failed\n"); grid = -1; return; }
        if (hipOccupancyMaxActiveBlocksPerMultiprocessor(&per_cu, (const void*)fwd_megakernel, NWAVES * 64, LDS_BYTES) != hipSuccess || per_cu < 1) { per_cu = 1; (void)hipGetLastError(); }
        grid = cus * per_cu;
    }
    if (grid < 0) return;
    Args a{};
    for (int i = 0; i < 14; ++i) a.in[i] = (const float*)d_in[i];
    a.out = (float*)d_out; a.ws = (unsigned char*)d_ws;
    void* kargs[] = {&a};
    const hipError_t e = hipLaunchCooperativeKernel((const void*)fwd_megakernel, dim3(grid), dim3(NWAVES * 64), kargs, LDS_BYTES, stream);
    if (e != hipSuccess) fprintf(stderr, "kernel_launch: cooperative launch failed: %s (grid %d)\n", hipGetErrorString(e), grid);
}
```

```cpp
#include <hip/hip_runtime.h>
#include <hip/hip_cooperative_groups.h>
#include <cstdio>
#include <cstdint>
namespace cg = cooperative_groups;
namespace pg8 {
#define PG8_LAS __attribute__((address_space(3)))
typedef unsigned short bf16_t;
typedef short bf16x8 __attribute__((ext_vector_type(8)));
typedef float f32x4 __attribute__((ext_vector_type(4)));
typedef unsigned u32x4 __attribute__((ext_vector_type(4)));
constexpr int BM = 256, BK = 64, HALF = 128, HTB = HALF * BK * 2  , STAGE_BYTES = 8 * HTB, NXCD = 8, WGM = 8;

__host__ __device__ __forceinline__ int lds_byte(int r, int c) { const int st = (r >> 4) * 2 + (c >> 5), rr = r & 15, cc = c & 31, ob = rr * 64 + cc * 2; return st * 1024 + (ob ^ (((ob >> 9) & 1) << 5)); }
__host__ __device__ __forceinline__ void stage_rc(int b, int& R, int& C) { const int st = b / 1024, sb = b % 1024, swz = sb ^ (((sb >> 9) & 1) << 5); R = (st >> 1) * 16 + swz / 64; C = (st & 1) * 32 + (swz % 64) / 2; }
__host__ __device__ __forceinline__ int perm32(int rho) { const int n = rho >> 4, i = rho & 15; return 8 * (i >> 2) + 4 * n + (i & 3); }

struct Unit { int pm, pn; };
struct Gemm { const bf16_t* A; const bf16_t* Bt; int M, N, K; };

struct StaticOrder {
    int nM, nN, nwg, G, c;
    __host__ __device__ void init(int M, int N, int G_, int c_) { nM = M / BM; nN = N / BM; nwg = nM * nN; G = G_; c = c_; }
    __host__ __device__ bool next(int i, Unit& u) const {
        const long L = (long)i * G + c; if (L >= nwg) return false;
        int wgid = (int)L; { const int q = nwg / NXCD, r = nwg % NXCD, xcd = wgid % NXCD, off = wgid / NXCD; wgid = (xcd < r ? xcd * (q + 1) : r * (q + 1) + (xcd - r) * q) + off; }
        const int nig = WGM * nN, gid = wgid / nig, fm = gid * WGM, gsz = (nM - fm) < WGM ? (nM - fm) : WGM;
        u.pm = fm + ((wgid % nig) % gsz); u.pn = (wgid % nig) / gsz; return true;
    }
    __device__ __forceinline__ void a_ready(const Unit&) const {}
    __device__ __forceinline__ void done(const Unit&) const {}
};

__device__ __forceinline__ unsigned cvt_pk_bf16(float lo, float hi) { unsigned r; asm volatile("v_cvt_pk_bf16_f32 %0, %1, %2" : "=v"(r) : "v"(lo), "v"(hi)); return r; }
typedef float f32x2 __attribute__((ext_vector_type(2)));
typedef unsigned u32x2 __attribute__((ext_vector_type(2)));
constexpr int E_SEQ = 8192, E_DM = 1024, E_NMOD = 6144, E_DFF = 2816, E_NFI = 5632, E_ZLD = 5376;
constexpr float E_EPS = 1e-6f;

struct EpiZ {
    static constexpr bool PERM = true, AFTER_DRAIN = false;
    bf16_t* Q; bf16_t* Z; const float* bias;
    __device__ __forceinline__ void operator()(const f32x4 (&acc)[2][2][4][2], const Unit& u, int wr, int wc, int fr, int fq) const {
        const int row0 = u.pm * BM + wr * 64 + fr; const int colt = u.pn * BM;
        bf16_t* base; int ldc;
        if (u.pn < 4) { base = Q + colt; ldc = E_DM; } else { base = Z + (colt - E_DM); ldc = E_ZLD; }
        const int col0 = wc * 32 + 8 * fq, bcol0 = colt + wc * 32 + 8 * fq;
        f32x4 bv[2][2];
#pragma unroll
        for (int bj = 0; bj < 2; ++bj)
#pragma unroll
            for (int n = 0; n < 2; ++n) bv[bj][n] = *(const f32x4*)(bias + bcol0 + bj * HALF + 4 * n);
#pragma unroll
        for (int ai = 0; ai < 2; ++ai)
#pragma unroll
            for (int m = 0; m < 4; ++m) { bf16_t* rowp = base + (size_t)(row0 + ai * HALF + m * 16) * ldc + col0;
#pragma unroll
                for (int bj = 0; bj < 2; ++bj) { const f32x4 v0 = acc[ai][bj][m][0] + bv[bj][0], v1 = acc[ai][bj][m][1] + bv[bj][1];
                    u32x4 w; w.x = cvt_pk_bf16(v0[0], v0[1]); w.y = cvt_pk_bf16(v0[2], v0[3]); w.z = cvt_pk_bf16(v1[0], v1[1]); w.w = cvt_pk_bf16(v1[2], v1[3]);
                    *(u32x4*)(rowp + bj * HALF) = w; } }
    }
};

template <bool WITH_XN> struct EpiRes {
    static constexpr bool PERM = false, AFTER_DRAIN = false;
    const float* xi; float* xo; const float* gate;
    float* ssq; bf16_t* xn; const float* gnorm; const float* scale;
    __device__ __forceinline__ void operator()(const f32x4 (&acc)[2][2][4][2], const Unit& u, int wr, int wc, int fr, int fq) const {
        const int b = (u.pm * BM) / E_SEQ;
        const int col0 = u.pn * BM + wc * 32 + 4 * fq;
        f32x4 ga[2][2], ge[2][2];
#pragma unroll
        for (int bj = 0; bj < 2; ++bj)
#pragma unroll
            for (int n = 0; n < 2; ++n) { const int c = col0 + bj * HALF + n * 16; ga[bj][n] = *(const f32x4*)(gate + b * E_NMOD + c);
                if (WITH_XN) { const f32x4 g = *(const f32x4*)(gnorm + c), s = *(const f32x4*)(scale + b * E_NMOD + c); ge[bj][n] = g * (s + 1.0f); } }
#pragma unroll
        for (int ai = 0; ai < 2; ++ai)
#pragma unroll
            for (int m = 0; m < 4; ++m) { const int r = u.pm * BM + ai * HALF + wr * 64 + m * 16 + fr; const size_t off = (size_t)r * E_DM + col0; float ss = 0.f;
#pragma unroll
                for (int bj = 0; bj < 2; ++bj)
#pragma unroll
                    for (int n = 0; n < 2; ++n) { const f32x4 xv = *(const f32x4*)(xi + off + bj * HALF + n * 16); const f32x4 v = xv + ga[bj][n] * acc[ai][bj][m][n];
                        *(f32x4*)(xo + off + bj * HALF + n * 16) = v; ss += (v[0] * v[0] + v[1] * v[1]) + (v[2] * v[2] + v[3] * v[3]);
                        if (WITH_XN) { const f32x4 a = v * ge[bj][n]; u32x2 w; w.x = cvt_pk_bf16(a[0], a[1]); w.y = cvt_pk_bf16(a[2], a[3]); *(u32x2*)(xn + off + bj * HALF + n * 16) = w; } }
                ss += __shfl_xor(ss, 16); ss += __shfl_xor(ss, 32);
                if (fq == 0) ssq[(size_t)r * 16 + u.pn * 4 + wc] = ss; }
    }
};

struct EpiSwi {
    static constexpr bool PERM = true, AFTER_DRAIN = false;
    bf16_t* H; const float* bias2; const float* ssq;
    __device__ __forceinline__ void operator()(const f32x4 (&acc)[2][2][4][2], const Unit& u, int wr, int wc, int fr, int fq) const {
        const int b = (u.pm * BM) / E_SEQ;
        const int bcol0 = u.pn * BM + wc * 32 + 8 * fq, hcol0 = u.pn * HALF + wc * 32 + 8 * fq;
        f32x4 bg[2], bu[2];
#pragma unroll
        for (int n = 0; n < 2; ++n) { bg[n] = *(const f32x4*)(bias2 + b * E_NFI + bcol0 + 4 * n); bu[n] = *(const f32x4*)(bias2 + b * E_NFI + bcol0 + HALF + 4 * n); }
#pragma unroll
        for (int ai = 0; ai < 2; ++ai)
#pragma unroll
            for (int m = 0; m < 4; ++m) { const int r = u.pm * BM + ai * HALF + wr * 64 + m * 16 + fr;
                const f32x4* sp = (const f32x4*)(ssq + (size_t)r * 16); const f32x4 s0 = sp[0], s1 = sp[1], s2 = sp[2], s3 = sp[3];
                const float tot = ((s0[0] + s0[1]) + (s0[2] + s0[3])) + ((s1[0] + s1[1]) + (s1[2] + s1[3])) + ((s2[0] + s2[1]) + (s2[2] + s2[3])) + ((s3[0] + s3[1]) + (s3[2] + s3[3]));
                const float rstd = __builtin_amdgcn_rsqf(tot * (1.0f / E_DM) + E_EPS);
                float hv[8];
#pragma unroll
                for (int n = 0; n < 2; ++n)
#pragma unroll
                    for (int e = 0; e < 4; ++e) { const float g = acc[ai][0][m][n][e] * rstd + bg[n][e], uu = acc[ai][1][m][n][e] * rstd + bu[n][e];
                        const float sg = g * __builtin_amdgcn_rcpf(1.0f + __builtin_amdgcn_exp2f(-1.4426950408889634f * g)); hv[4 * n + e] = sg * uu; }
                u32x4 w; w.x = cvt_pk_bf16(hv[0], hv[1]); w.y = cvt_pk_bf16(hv[2], hv[3]); w.z = cvt_pk_bf16(hv[4], hv[5]); w.w = cvt_pk_bf16(hv[6], hv[7]);
                *(u32x4*)(H + (size_t)r * E_DFF + hcol0) = w; }
    }
};

template <class Epi, class Sched, bool ALIGN_EPI = false, bool SP2 = false>
__device__ __forceinline__ void gemm_phase(PG8_LAS unsigned char* lds, const Gemm g, const Sched& S, const Epi& E) {
    const int tid = threadIdx.x, wid = __builtin_amdgcn_readfirstlane(tid >> 6), lane = tid & 63, wr = wid >> 2, wc = wid & 3, fr = lane & 15, fq = lane >> 4;
    const int K = g.K, nt = K / BK;
    unsigned voffA[2], voffB[2];
#pragma unroll
    for (int i = 0; i < 2; ++i) { int R, C; stage_rc(tid * 16 + i * 8192, R, C); const int Rb = Epi::PERM ? ((R & ~31) + perm32(R & 31)) : R;
        voffA[i] = (unsigned)(R * K + C) * 2u; voffB[i] = (unsigned)(Rb * K + C) * 2u; }
    const size_t kstep = (size_t)(BK * 2);
    const size_t hstep = (size_t)HALF * K * 2;
    const size_t tstep = 2 * hstep;
    const unsigned ldsw = (unsigned)wid * 1024u;
    const int aoff = lds_byte(wr * 64 + fr, fq * 8), boff = lds_byte(wc * 32 + fr, fq * 8);
#define PG8_SA(b, h) (((b) * 2 + (h)) * HTB)
#define PG8_SB(b, h) ((4 + (b) * 2 + (h)) * HTB)
#define PG8_STAGE(bufoff, gbase, voff) do { _Pragma("unroll") for (int _i = 0; _i < 2; ++_i) \
        __builtin_amdgcn_global_load_lds((const unsigned*)((const char*)(gbase) + (voff)[_i]), (PG8_LAS unsigned*)(lds + (bufoff) + ldsw + _i * 8192), 16, 0, 0); } while (0)
#define PG8_LDA(dst, b, h) do { _Pragma("unroll") for (int m = 0; m < 4; ++m) _Pragma("unroll") for (int k = 0; k < 2; ++k) dst[m][k] = *(const PG8_LAS bf16x8*)(lds + PG8_SA(b, h) + aoff + m * 2048 + k * 1024); } while (0)
#define PG8_LDB(dst, b, h) do { _Pragma("unroll") for (int n = 0; n < 2; ++n) _Pragma("unroll") for (int k = 0; k < 2; ++k) dst[n][k] = *(const PG8_LAS bf16x8*)(lds + PG8_SB(b, h) + boff + n * 2048 + k * 1024); } while (0)
#define PG8_MMA(ai, bj, At, Bt) do { __builtin_amdgcn_s_setprio(1); _Pragma("unroll") for (int m = 0; m < 4; ++m) _Pragma("unroll") for (int n = 0; n < 2; ++n) _Pragma("unroll") for (int k = 0; k < 2; ++k) \
        acc[ai][bj][m][n] = __builtin_amdgcn_mfma_f32_16x16x32_bf16(Bt[n][k], At[m][k], acc[ai][bj][m][n], 0, 0, 0); __builtin_amdgcn_s_setprio(0); } while (0)
#define PG8_WAIT_V(n) asm volatile("s_waitcnt vmcnt(" #n ")" ::: "memory")
#define PG8_WAIT_L(n) asm volatile("s_waitcnt lgkmcnt(" #n ")" ::: "memory")
#define PG8_BAR __builtin_amdgcn_s_barrier()
#define PG8_SCHED __builtin_amdgcn_sched_barrier(0)
    Unit cur, nxt; int ui = 0;
    if (!S.next(0, cur)) return;
    f32x4 acc[2][2][4][2];
#pragma unroll
    for (int a = 0; a < 2; ++a)
#pragma unroll
        for (int b = 0; b < 2; ++b)
#pragma unroll
            for (int m = 0; m < 4; ++m)
#pragma unroll
                for (int n = 0; n < 2; ++n) acc[a][b][m][n] = (f32x4){0.f, 0.f, 0.f, 0.f};
    bf16x8 At[4][2], B0[2][2], B1[2][2];
    const char* cA = (const char*)g.A + (size_t)cur.pm * tstep; const char* cB = (const char*)g.Bt + (size_t)cur.pn * tstep;
    S.a_ready(cur);
    if constexpr (SP2) {
        PG8_STAGE(PG8_SB(0, 0), cB, voffB); PG8_STAGE(PG8_SB(0, 1), cB + hstep, voffB); PG8_STAGE(PG8_SA(0, 0), cA, voffA); PG8_STAGE(PG8_SA(0, 1), cA + hstep, voffA);
        if (wr == 1) PG8_BAR;
        PG8_WAIT_V(2); PG8_BAR;
        PG8_STAGE(PG8_SB(1, 0), cB + kstep, voffB); PG8_STAGE(PG8_SA(1, 0), cA + kstep, voffA); PG8_STAGE(PG8_SB(1, 1), cB + hstep + kstep, voffB);
        PG8_WAIT_V(6); PG8_BAR;
    } else {
        PG8_STAGE(PG8_SB(0, 0), cB, voffB); PG8_STAGE(PG8_SA(0, 0), cA, voffA); PG8_STAGE(PG8_SB(0, 1), cB + hstep, voffB); PG8_STAGE(PG8_SA(0, 1), cA + hstep, voffA);
        if (wr == 1) PG8_BAR;
        PG8_WAIT_V(4); PG8_BAR;
        PG8_STAGE(PG8_SB(1, 0), cB + kstep, voffB); PG8_STAGE(PG8_SA(1, 0), cA + kstep, voffA); PG8_STAGE(PG8_SB(1, 1), cB + hstep + kstep, voffB);
        PG8_WAIT_V(6); PG8_BAR;
    }
    for (;;) {
        const bool has_next = S.next(ui + 1, nxt);
        const char* nA = has_next ? (const char*)g.A + (size_t)nxt.pm * tstep : cA; const char* nB = has_next ? (const char*)g.Bt + (size_t)nxt.pn * tstep : cB;
        for (int t = 0; t < nt; t += 2) {
            const bool last = (t == nt - 2);
            const char* a1 = cA + (size_t)(t + 1) * kstep;
            const char* a2 = last ? nA : cA + (size_t)(t + 2) * kstep; const char* b2 = last ? nB : cB + (size_t)(t + 2) * kstep;
            const char* a3 = a2 + kstep; const char* b3 = b2 + kstep;
            if (last && has_next) S.a_ready(nxt);
            if constexpr (SP2) {
            PG8_LDB(B0, 0, 0); PG8_LDB(B1, 0, 1); PG8_SCHED; PG8_LDA(At, 0, 0); PG8_STAGE(PG8_SA(1, 1), a1 + hstep, voffA);
            PG8_WAIT_V(8); PG8_WAIT_L(0); PG8_BAR; PG8_MMA(0, 0, At, B0); PG8_MMA(0, 1, At, B1); PG8_BAR; PG8_SCHED;
            PG8_LDA(At, 0, 1); PG8_STAGE(PG8_SB(0, 0), b2, voffB); PG8_STAGE(PG8_SB(0, 1), b2 + hstep, voffB); PG8_STAGE(PG8_SA(0, 0), a2, voffA);
            PG8_WAIT_V(8); PG8_WAIT_L(0); PG8_BAR; PG8_MMA(1, 0, At, B0); PG8_MMA(1, 1, At, B1); PG8_BAR; PG8_SCHED;
            PG8_LDB(B0, 1, 0); PG8_LDB(B1, 1, 1); PG8_SCHED; PG8_LDA(At, 1, 0); PG8_STAGE(PG8_SA(0, 1), a2 + hstep, voffA);
            PG8_WAIT_V(8); PG8_WAIT_L(0); PG8_BAR; PG8_MMA(0, 0, At, B0); PG8_MMA(0, 1, At, B1); PG8_BAR; PG8_SCHED;
            PG8_LDA(At, 1, 1); PG8_STAGE(PG8_SB(1, 0), b3, voffB); PG8_STAGE(PG8_SB(1, 1), b3 + hstep, voffB); PG8_STAGE(PG8_SA(1, 0), a3, voffA);
            PG8_WAIT_V(8); PG8_WAIT_L(0); PG8_BAR; PG8_MMA(1, 0, At, B0); PG8_MMA(1, 1, At, B1); PG8_BAR; PG8_SCHED;
            } else {
            PG8_LDB(B0, 0, 0); PG8_SCHED; PG8_LDA(At, 0, 0); PG8_STAGE(PG8_SA(1, 1), a1 + hstep, voffA);
            PG8_WAIT_L(8); PG8_BAR; PG8_WAIT_L(0); PG8_MMA(0, 0, At, B0); PG8_BAR; PG8_SCHED;
            PG8_LDB(B1, 0, 1); PG8_STAGE(PG8_SB(0, 0), b2, voffB);
            PG8_BAR; PG8_WAIT_L(0); PG8_MMA(0, 1, At, B1); PG8_BAR;
            PG8_LDA(At, 0, 1); PG8_STAGE(PG8_SA(0, 0), a2, voffA);
            PG8_BAR; PG8_WAIT_L(0); PG8_MMA(1, 0, At, B0); PG8_BAR; PG8_SCHED;
            PG8_STAGE(PG8_SB(0, 1), b2 + hstep, voffB);
            PG8_WAIT_V(6); PG8_BAR; PG8_MMA(1, 1, At, B1); PG8_BAR;
            PG8_LDB(B0, 1, 0); PG8_SCHED; PG8_LDA(At, 1, 0); PG8_STAGE(PG8_SA(0, 1), a2 + hstep, voffA);
            PG8_WAIT_L(8); PG8_BAR; PG8_WAIT_L(0); PG8_MMA(0, 0, At, B0); PG8_BAR; PG8_SCHED;
            PG8_LDB(B1, 1, 1); PG8_STAGE(PG8_SB(1, 0), b3, voffB);
            PG8_BAR; PG8_WAIT_L(0); PG8_MMA(0, 1, At, B1); PG8_BAR;
            PG8_LDA(At, 1, 1); PG8_STAGE(PG8_SA(1, 0), a3, voffA);
            PG8_BAR; PG8_WAIT_L(0); PG8_MMA(1, 0, At, B0); PG8_BAR; PG8_SCHED;
            PG8_STAGE(PG8_SB(1, 1), b3 + hstep, voffB);
            PG8_WAIT_V(6); PG8_BAR; PG8_MMA(1, 1, At, B1); PG8_BAR;
            }
        }
        if constexpr (ALIGN_EPI) { if (wr == 0) PG8_BAR; }
        if constexpr (!Epi::AFTER_DRAIN) { E(acc, cur, wr, wc, fr, fq); S.done(cur); }
        if (!has_next) break;
#pragma unroll
        for (int a = 0; a < 2; ++a)
#pragma unroll
            for (int b = 0; b < 2; ++b)
#pragma unroll
                for (int m = 0; m < 4; ++m)
#pragma unroll
                    for (int n = 0; n < 2; ++n) acc[a][b][m][n] = (f32x4){0.f, 0.f, 0.f, 0.f};
        cur = nxt; cA = nA; cB = nB; ++ui;
        if constexpr (ALIGN_EPI) { if (wr == 1) PG8_BAR; }
    }
    PG8_WAIT_V(0);
    if constexpr (!ALIGN_EPI) { if (wr == 0) PG8_BAR; }
    PG8_BAR;
    if constexpr (Epi::AFTER_DRAIN) { E.fused(acc, cur, wr, wc, fr, fq, lds, wid, lane); S.done(cur); }
#undef PG8_SA
#undef PG8_SB
#undef PG8_STAGE
#undef PG8_LDA
#undef PG8_LDB
#undef PG8_MMA
#undef PG8_WAIT_V
#undef PG8_WAIT_L
#undef PG8_BAR
#undef PG8_SCHED
}
}

constexpr int NWAVES = 8;
constexpr int BATCH = 2, SEQ = 8192, DM = 1024, M = BATCH * SEQ;
constexpr int NIN = 6400, DFF = 2816, NFI = 2 * DFF, NMOD = 6144, ZLD = 5376;
constexpr int ZC_K = 0, ZC_V = 128, ZC_CB = 256, ZC_CC = 1280, ZC_CX = 2304, ZC_GA = 3328, ZC_GC = 4352;
constexpr int MOD_SH1 = 0, MOD_SC1 = 1024, MOD_GA1 = 2048, MOD_SH2 = 3072, MOD_SC2 = 4096, MOD_GA2 = 5120;
constexpr float EPS = 1e-6f;
static_assert(pg8::E_ZLD == ZLD && pg8::E_NFI == NFI && pg8::E_DFF == DFF && pg8::E_NMOD == NMOD && pg8::E_DM == DM && pg8::E_SEQ == SEQ, "epilogue constants");

constexpr size_t MiB = 1u << 20;
constexpr size_t WS_MOD = 0;
constexpr size_t WS_BIAS2 = 64 * 1024;
constexpr size_t WS_SSQ1 = 1 * MiB, WS_SSQ2 = 2 * MiB;
constexpr size_t WS_WIN = 4 * MiB;
constexpr size_t WS_WOUT = 17 * MiB;
constexpr size_t WS_WFI = 19 * MiB;
constexpr size_t WS_WFO = 30 * MiB;
constexpr size_t WS_Z = 36 * MiB;
constexpr size_t WS_H = WS_Z;
constexpr size_t WS_XN2 = WS_Z + 96 * MiB;
constexpr size_t WS_MG = 204 * MiB;
constexpr size_t WS_END = 236 * MiB;

constexpr int RING_BYTES = 131072;
constexpr int SCR_BYTES = 64 * 65 * 4;
constexpr int LDS_SV = NWAVES * SCR_BYTES, LDS_RED = LDS_SV + 8192;
constexpr int A_KS = 0, A_VT = 36864, A_OST = 70656;
constexpr int LDS_BYTES = 147456;
static_assert(A_OST + NWAVES * 8704 <= LDS_BYTES && LDS_RED + 2048 <= LDS_BYTES, "LDS map");

#define LAS __attribute__((address_space(3)))
typedef unsigned short bf16;
typedef unsigned v4u __attribute__((ext_vector_type(4)));
typedef float f32x4 __attribute__((ext_vector_type(4)));
typedef float f32x16 __attribute__((ext_vector_type(16)));
typedef short bf16x8 __attribute__((ext_vector_type(8)));

__device__ __forceinline__ unsigned f2bf(float f) { unsigned u = __builtin_bit_cast(unsigned, f); return (u + 0x7fffu + ((u >> 16) & 1u)) >> 16; }
__device__ __forceinline__ unsigned pk2(float lo, float hi) { return f2bf(lo) | (f2bf(hi) << 16); }
__device__ __forceinline__ float bflo(unsigned w) { return __builtin_bit_cast(float, w << 16); }
__device__ __forceinline__ float bfhi(unsigned w) { return __builtin_bit_cast(float, w & 0xffff0000u); }
__device__ __forceinline__ float sigmoidf_(float v) { return __builtin_amdgcn_rcpf(1.0f + __builtin_amdgcn_exp2f(-1.4426950408889634f * v)); }
__device__ __forceinline__ float wave_sum(float v) {
#pragma unroll
    for (int o = 1; o < 64; o <<= 1) v += __shfl_xor(v, o);
    return v;
}

__device__ __forceinline__ void transpose_item(const float* __restrict__ W, int K, int N, bf16* __restrict__ WT, int dest_row0, LAS float* scr, int k0, int n0, int lane) {
    const int r = lane >> 4, c4 = (lane & 15) * 4;
    f32x4 v[16];
#pragma unroll
    for (int i = 0; i < 16; ++i) v[i] = *(const f32x4*)(W + (size_t)(k0 + 4 * i + r) * N + n0 + c4);
#pragma unroll
    for (int i = 0; i < 16; ++i) { LAS float* p = scr + (4 * i + r) * 65 + c4; p[0] = v[i].x; p[1] = v[i].y; p[2] = v[i].z; p[3] = v[i].w; }
    asm volatile("s_waitcnt lgkmcnt(0)" ::: "memory");
    const int c = lane & 7;
#pragma unroll
    for (int j = 0; j < 8; ++j) { const int n = (lane >> 3) + 8 * j; const LAS float* s = scr + (8 * c) * 65 + n;
        v4u o; o.x = pk2(s[0 * 65], s[1 * 65]); o.y = pk2(s[2 * 65], s[3 * 65]); o.z = pk2(s[4 * 65], s[5 * 65]); o.w = pk2(s[6 * 65], s[7 * 65]);
        *(v4u*)(WT + (size_t)(dest_row0 + n) * K + k0 + 8 * c) = o; }
    asm volatile("s_waitcnt lgkmcnt(0)" ::: "memory");
}
__device__ __forceinline__ int ffi_dest(int n) { const int j = n < DFF ? n : n - DFF; return 256 * (j >> 7) + (n < DFF ? 0 : 128) + (j & 127); }

__device__ __forceinline__ float gemv32(const float* __restrict__ W, int N, int n0, const LAS float* sv, LAS float* red, int tid, int wave, int lane) {
    const int hi = lane >> 5, l31 = lane & 31;
    const float* wp = W + (size_t)(wave * 128 + hi) * N + n0 + l31;
    float wv[64];
#pragma unroll
    for (int i = 0; i < 64; ++i) wv[i] = wp[(size_t)(2 * i) * N];
    float a0 = 0.f, a1 = 0.f;
#pragma unroll
    for (int i = 0; i < 64; ++i) { const int k = wave * 128 + 2 * i + hi; a0 += sv[k] * wv[i]; a1 += sv[1024 + k] * wv[i]; }
    a0 += __shfl_xor(a0, 32); a1 += __shfl_xor(a1, 32);
    if (lane < 32) { red[(wave * 2 + 0) * 32 + l31] = a0; red[(wave * 2 + 1) * 32 + l31] = a1; }
    __syncthreads();
    float s = 0.f;
    if (tid < 64) { const int b = tid >> 5;
#pragma unroll
        for (int w = 0; w < 8; ++w) s += red[(w * 2 + b) * 32 + (tid & 31)]; }
    __syncthreads();
    return s;
}

__device__ __forceinline__ void attn_unit(int b, int nb, int kvh, const bf16* __restrict__ Qb, const bf16* __restrict__ Z, const float* __restrict__ sinks, const float* __restrict__ convw,
                                          bf16* __restrict__ MG, LAS unsigned char* lds, int tid, int wid, int lane) {
    const int l31 = lane & 31, hi = lane >> 5;
    const size_t rowbase = (size_t)b * SEQ; const int t0 = nb * 128;
#pragma unroll
    for (int i = 0; i < 4; ++i) {
        const int c = tid + 512 * i, key = c >> 3, part = c & 7, t = t0 - 128 + key;
        v4u kv = {0u, 0u, 0u, 0u}, vv = {0u, 0u, 0u, 0u};
        if (t >= 0) { const bf16* zr = Z + (rowbase + t) * ZLD + kvh * 64 + part * 8; kv = *(const v4u*)(zr + ZC_K); vv = *(const v4u*)(zr + ZC_V); }
        *(LAS v4u*)(lds + A_KS + key * 144 + part * 16) = kv;
        LAS unsigned short* vt = (LAS unsigned short*)(lds + A_VT + (part * 8) * 528 + key * 2);
        vt[0 * 264] = (unsigned short)(vv.x & 0xffffu); vt[1 * 264] = (unsigned short)(vv.x >> 16);
        vt[2 * 264] = (unsigned short)(vv.y & 0xffffu); vt[3 * 264] = (unsigned short)(vv.y >> 16);
        vt[4 * 264] = (unsigned short)(vv.z & 0xffffu); vt[5 * 264] = (unsigned short)(vv.z >> 16);
        vt[6 * 264] = (unsigned short)(vv.w & 0xffffu); vt[7 * 264] = (unsigned short)(vv.w >> 16);
    }
    __syncthreads();
    const int h = kvh * 8 + wid;
    const float LOG2E = 1.4426950408889634f, C2 = 0.125f * LOG2E;
    const float sink2 = sinks[h] * LOG2E;
    const int ch = h * 64 + (lane & 7) * 8;
    float cw0[8], cw1[8], cw2[8];
#pragma unroll
    for (int e = 0; e < 8; ++e) { cw0[e] = convw[ch + e]; cw1[e] = convw[DM + ch + e]; cw2[e] = convw[2 * DM + ch + e]; }
    const int kap = (l31 & ~12) | ((l31 & 4) << 1) | ((l31 & 8) >> 1);
    const LAS unsigned char* kbase = lds + A_KS + kap * 144 + hi * 16;
    const LAS unsigned char* vbase = lds + A_VT + l31 * 528 + hi * 16;
    LAS float* ost = (LAS float*)(lds + A_OST + wid * 8704);
    const bool nb0 = (nb == 0);
#pragma unroll 1
    for (int qs = 0; qs < 4; ++qs) {
        const bf16* qrow = Qb + (rowbase + t0 + 32 * qs + l31) * DM + h * 64 + hi * 8;
        bf16x8 qr[4];
#pragma unroll
        for (int d0 = 0; d0 < 4; ++d0) qr[d0] = *(const bf16x8*)(qrow + 16 * d0);
        f32x16 s[5];
#pragma unroll
        for (int kt = 0; kt < 5; ++kt) {
            const LAS unsigned char* kp = kbase + (32 * (qs + kt)) * 144;
            f32x16 a = {0.f, 0.f, 0.f, 0.f, 0.f, 0.f, 0.f, 0.f, 0.f, 0.f, 0.f, 0.f, 0.f, 0.f, 0.f, 0.f};
#pragma unroll
            for (int d0 = 0; d0 < 4; ++d0) a = __builtin_amdgcn_mfma_f32_32x32x16_bf16(*(const LAS bf16x8*)(kp + d0 * 32), qr[d0], a, 0, 0, 0);
            s[kt] = a;
        }
        float mx = sink2;
#pragma unroll
        for (int kt = 0; kt < 5; ++kt) {
            const bool tile_ok = !nb0 || (qs + kt >= 4);
#pragma unroll
            for (int r = 0; r < 16; ++r) {
                const int kk = (r & 7) + 8 * hi + 16 * (r >> 3);
                bool valid = tile_ok;
                if (kt == 0) valid = valid && (kk > l31);
                if (kt == 4) valid = valid && (kk <= l31);
                const float v = valid ? s[kt][r] * C2 : -INFINITY;
                s[kt][r] = v; mx = fmaxf(mx, v);
            }
        }
        mx = fmaxf(mx, __shfl_xor(mx, 32));
        float sum = 0.f;
#pragma unroll
        for (int kt = 0; kt < 5; ++kt)
#pragma unroll
            for (int r = 0; r < 16; ++r) { const float p = __builtin_amdgcn_exp2f(s[kt][r] - mx); s[kt][r] = p; sum += p; }
        sum += __shfl_xor(sum, 32);
        const float inv = 1.0f / (sum + __builtin_amdgcn_exp2f(sink2 - mx));
        f32x16 o0 = {0.f, 0.f, 0.f, 0.f, 0.f, 0.f, 0.f, 0.f, 0.f, 0.f, 0.f, 0.f, 0.f, 0.f, 0.f, 0.f}, o1 = o0;
#pragma unroll
        for (int kt = 0; kt < 5; ++kt)
#pragma unroll
            for (int ss = 0; ss < 2; ++ss) {
                v4u pw; pw.x = pg8::cvt_pk_bf16(s[kt][8 * ss + 0], s[kt][8 * ss + 1]); pw.y = pg8::cvt_pk_bf16(s[kt][8 * ss + 2], s[kt][8 * ss + 3]);
                pw.z = pg8::cvt_pk_bf16(s[kt][8 * ss + 4], s[kt][8 * ss + 5]); pw.w = pg8::cvt_pk_bf16(s[kt][8 * ss + 6], s[kt][8 * ss + 7]);
                const bf16x8 pf = __builtin_bit_cast(bf16x8, pw);
                const LAS unsigned char* vp = vbase + (32 * (qs + kt) + 16 * ss) * 2;
                o0 = __builtin_amdgcn_mfma_f32_32x32x16_bf16(*(const LAS bf16x8*)(vp), pf, o0, 0, 0, 0);
                o1 = __builtin_amdgcn_mfma_f32_32x32x16_bf16(*(const LAS bf16x8*)(vp + 32 * 528), pf, o1, 0, 0, 0);
            }
#pragma unroll
        for (int g = 0; g < 4; ++g) {
            *(LAS f32x4*)(ost + l31 * 68 + 8 * g + 4 * hi) = (f32x4){o0[4 * g + 0] * inv, o0[4 * g + 1] * inv, o0[4 * g + 2] * inv, o0[4 * g + 3] * inv};
            *(LAS f32x4*)(ost + l31 * 68 + 32 + 8 * g + 4 * hi) = (f32x4){o1[4 * g + 0] * inv, o1[4 * g + 1] * inv, o1[4 * g + 2] * inv, o1[4 * g + 3] * inv};
        }
#pragma unroll
        for (int i = 0; i < 4; ++i) {
            const int row = (lane >> 3) + 8 * i, t = t0 + 32 * qs + row;
            const f32x4 oa = *(const LAS f32x4*)(ost + row * 68 + (lane & 7) * 8), ob = *(const LAS f32x4*)(ost + row * 68 + (lane & 7) * 8 + 4);
            const bf16* zr = Z + (rowbase + t) * ZLD + ch;
            const v4u ga = *(const v4u*)(zr + ZC_GA), gc = *(const v4u*)(zr + ZC_GC), cb = *(const v4u*)(zr + ZC_CB);
            const v4u c0 = *(const v4u*)(zr + ZC_CC), x0 = *(const v4u*)(zr + ZC_CX);
            v4u c1 = {0u, 0u, 0u, 0u}, x1 = c1, c2 = c1, x2 = c1;
            if (t >= 1) { c1 = *(const v4u*)(zr - ZLD + ZC_CC); x1 = *(const v4u*)(zr - ZLD + ZC_CX); }
            if (t >= 2) { c2 = *(const v4u*)(zr - 2 * ZLD + ZC_CC); x2 = *(const v4u*)(zr - 2 * ZLD + ZC_CX); }
            float mg[8];
#pragma unroll
            for (int e = 0; e < 8; ++e) {
                const int w = e >> 1; const bool up = (e & 1);
                const float fga = up ? bfhi(ga[w]) : bflo(ga[w]), fgc = up ? bfhi(gc[w]) : bflo(gc[w]), fcb = up ? bfhi(cb[w]) : bflo(cb[w]);
                const float u0 = (up ? bfhi(c0[w]) : bflo(c0[w])) * (up ? bfhi(x0[w]) : bflo(x0[w]));
                const float u1 = (up ? bfhi(c1[w]) : bflo(c1[w])) * (up ? bfhi(x1[w]) : bflo(x1[w]));
                const float u2 = (up ? bfhi(c2[w]) : bflo(c2[w])) * (up ? bfhi(x2[w]) : bflo(x2[w]));
                const float conv = cw0[e] * u2 + cw1[e] * u1 + cw2[e] * u0;
                const float att = (e < 4) ? oa[e & 3] : ob[e & 3];
                mg[e] = sigmoidf_(fga) * att + sigmoidf_(fgc) * fcb * conv;
            }
            v4u o; o.x = pg8::cvt_pk_bf16(mg[0], mg[1]); o.y = pg8::cvt_pk_bf16(mg[2], mg[3]); o.z = pg8::cvt_pk_bf16(mg[4], mg[5]); o.w = pg8::cvt_pk_bf16(mg[6], mg[7]);
            *(v4u*)(MG + (rowbase + t) * DM + ch) = o;
        }
    }
    __syncthreads();
}

struct Args { const float* in[14]; float* out; unsigned char* ws; };
__global__ void __launch_bounds__(NWAVES * 64, 2) fwd_megakernel(Args args) {
    extern __shared__ __attribute__((aligned(16))) unsigned char lds_raw[];
    cg::grid_group grid = cg::this_grid();
    LAS unsigned char* lds = (LAS unsigned char*)lds_raw;
    const int tid = threadIdx.x, lane = tid & 63, wave = __builtin_amdgcn_readfirstlane(tid >> 6);
    const int G = gridDim.x, bx = blockIdx.x;
    const int vcu = (G % 8 == 0) ? (bx % 8) * (G / 8) + bx / 8 : bx;
    const int gw = vcu * NWAVES + wave, NGW = G * NWAVES;
    const float* x = args.in[0]; const float* cvec = args.in[1]; const float* w_ada = args.in[2]; const float* b_ada = args.in[3]; const float* g_mix = args.in[4];
    const float* w_in = args.in[5]; const float* b_in = args.in[6]; const float* sinks = args.in[7]; const float* conv_w = args.in[8]; const float* w_out = args.in[9];
    const float* g_ffn = args.in[10]; const float* w_ffn_in = args.in[11]; const float* w_ffn_out = args.in[12]; const float* g_final = args.in[13];
    float* out = args.out; unsigned char* ws = args.ws;
    float* mod = (float*)(ws + WS_MOD); float* bias2 = (float*)(ws + WS_BIAS2); float* ssq1 = (float*)(ws + WS_SSQ1); float* ssq2 = (float*)(ws + WS_SSQ2);
    bf16* Win_t = (bf16*)(ws + WS_WIN); bf16* Wout_t = (bf16*)(ws + WS_WOUT); bf16* Wfi_t = (bf16*)(ws + WS_WFI); bf16* Wfo_t = (bf16*)(ws + WS_WFO);
    bf16* Zb = (bf16*)(ws + WS_Z); bf16* Hb = (bf16*)(ws + WS_H); bf16* XN2 = (bf16*)(ws + WS_XN2); bf16* MG = (bf16*)(ws + WS_MG);
    bf16* XN = (bf16*)out; bf16* Qb = (bf16*)out + (size_t)M * DM;
    LAS float* sv = (LAS float*)(lds + LDS_SV); LAS float* red = (LAS float*)(lds + LDS_RED);

    {
        for (int i = tid; i < 2 * DM; i += NWAVES * 64) { const float cv = cvec[i]; sv[i] = cv * sigmoidf_(cv); }
        __syncthreads();
        for (int item = bx; item < NMOD / 32; item += G) {
            const int n0 = item * 32; const float s = gemv32(w_ada, NMOD, n0, sv, red, tid, wave, lane);
            if (tid < 64) mod[(tid >> 5) * NMOD + n0 + (tid & 31)] = s + b_ada[n0 + (tid & 31)];
        }
        LAS float* scr = (LAS float*)(lds + wave * SCR_BYTES);
        constexpr int I_IN = 16 * (NIN / 64), I_OUT = 16 * (DM / 64), I_FI = 16 * (NFI / 64), I_FO = (DFF / 64) * (DM / 64);
        for (int it = gw; it < I_IN + I_OUT + I_FI + I_FO; it += NGW) {
            int r = it;
            if (r < I_IN) { const int nblk = NIN / 64, kb = r / nblk, nbk = r % nblk; transpose_item(w_in, DM, NIN, Win_t, 64 * nbk, scr, 64 * kb, 64 * nbk, lane); continue; } r -= I_IN;
            if (r < I_OUT) { const int nblk = DM / 64, kb = r / nblk, nbk = r % nblk; transpose_item(w_out, DM, DM, Wout_t, 64 * nbk, scr, 64 * kb, 64 * nbk, lane); continue; } r -= I_OUT;
            if (r < I_FI) { const int nblk = NFI / 64, kb = r / nblk, nbk = r % nblk; transpose_item(w_ffn_in, DM, NFI, Wfi_t, ffi_dest(64 * nbk), scr, 64 * kb, 64 * nbk, lane); continue; } r -= I_FI;
            { const int nblk = DM / 64, kb = r / nblk, nbk = r % nblk; transpose_item(w_ffn_out, DFF, DM, Wfo_t, 64 * nbk, scr, 64 * kb, 64 * nbk, lane); }
        }
    }
    grid.sync();
    {
        for (int i = tid; i < 2 * DM; i += NWAVES * 64) sv[i] = mod[(i >> 10) * NMOD + MOD_SH2 + (i & 1023)];
        __syncthreads();
        for (int item = bx; item < NFI / 32; item += G) {
            const int n0 = item * 32; const float s = gemv32(w_ffn_in, NFI, n0, sv, red, tid, wave, lane);
            if (tid < 64) bias2[(tid >> 5) * NFI + ffi_dest(n0 + (tid & 31))] = s;
        }
        f32x4 v[4];
        if (gw < M) { const f32x4* xr = (const f32x4*)(x + (size_t)gw * DM) + lane;
#pragma unroll
            for (int j = 0; j < 4; ++j) v[j] = xr[64 * j]; }
        for (int m = gw; m < M; m += NGW) {
            const int b = m / SEQ, mn = (m + NGW < M) ? m + NGW : m;
            f32x4 nv[4]; { const f32x4* xr = (const f32x4*)(x + (size_t)mn * DM) + lane;
#pragma unroll
                for (int j = 0; j < 4; ++j) nv[j] = xr[64 * j]; }
            float s = 0.f;
#pragma unroll
            for (int j = 0; j < 4; ++j) s += (v[j].x * v[j].x + v[j].y * v[j].y) + (v[j].z * v[j].z + v[j].w * v[j].w);
            const float rstd = 1.0f / sqrtf(wave_sum(s) * (1.0f / DM) + EPS);
            unsigned long long* o8 = (unsigned long long*)(XN + (size_t)m * DM) + lane;
#pragma unroll
            for (int j = 0; j < 4; ++j) { const int c = 4 * lane + 256 * j;
                const f32x4 g = *(const f32x4*)(g_mix + c), sc = *(const f32x4*)(mod + b * NMOD + MOD_SC1 + c), sh = *(const f32x4*)(mod + b * NMOD + MOD_SH1 + c);
                const f32x4 y = v[j] * rstd * g * (sc + 1.0f) + sh;
                o8[64 * j] = (unsigned long long)pk2(y.x, y.y) | ((unsigned long long)pk2(y.z, y.w) << 32); }
#pragma unroll
            for (int j = 0; j < 4; ++j) v[j] = nv[j];
        }
    }
    grid.sync();
    {
        pg8::Gemm g{XN, Win_t, M, NIN, DM}; pg8::StaticOrder S; S.init(M, NIN, G, bx);
        pg8::EpiZ E{Qb, Zb, b_in};
        pg8::gemm_phase<pg8::EpiZ, pg8::StaticOrder, true, true>(lds, g, S, E);
    }
    grid.sync();
    for (int u = bx; u < BATCH * (SEQ / 128) * 2; u += G) attn_unit(u >> 7, (u >> 1) & 63, u & 1, Qb, Zb, sinks, conv_w, MG, lds, tid, wave, lane);
    grid.sync();
    {
        pg8::Gemm g{MG, Wout_t, M, DM, DM}; pg8::StaticOrder S; S.init(M, DM, G, bx);
        pg8::EpiRes<true> E{x, out, mod + MOD_GA1, ssq1, XN2, g_ffn, mod + MOD_SC2};
        pg8::gemm_phase<pg8::EpiRes<true>, pg8::StaticOrder, true, true>(lds, g, S, E);
    }
    grid.sync();
    {
        pg8::Gemm g{XN2, Wfi_t, M, NFI, DM}; pg8::StaticOrder S; S.init(M, NFI, G, bx);
        pg8::EpiSwi E{Hb, bias2, ssq1};
        pg8::gemm_phase<pg8::EpiSwi, pg8::StaticOrder, true, true>(lds, g, S, E);
    }
    grid.sync();
    {
        pg8::Gemm g{Hb, Wfo_t, M, DM, DFF}; pg8::StaticOrder S; S.init(M, DM, G, bx);
        pg8::EpiRes<false> E{out, out, mod + MOD_GA2, ssq2, nullptr, nullptr, nullptr};
        pg8::gemm_phase<pg8::EpiRes<false>, pg8::StaticOrder, true, true>(lds, g, S, E);
    }
    grid.sync();
    for (int m = gw; m < M; m += NGW) {
        const float sq = (lane < 16) ? ssq2[(size_t)m * 16 + lane] : 0.f;
        const float rstd = 1.0f / sqrtf(wave_sum(sq) * (1.0f / DM) + EPS);
        f32x4* xr = (f32x4*)(out + (size_t)m * DM) + lane;
#pragma unroll
        for (int j = 0; j < 4; ++j) { const f32x4 g = *(const f32x4*)(g_final + 4 * lane + 256 * j); xr[64 * j] = xr[64 * j] * rstd * g; }
    }
}

extern "C" void kernel_launch(void* const* d_in, const int* in_sizes, int n_in, void* d_out, int out_size, void* d_ws, size_t ws_size, hipStream_t stream) {
    static int grid = 0;
    if (grid == 0) {
        if (n_in != 14 || out_size != M * DM || ws_size < WS_END) { fprintf(stderr, "kernel_launch: unexpected shapes (n_in %d, out %d, ws %zu)\n", n_in, out_size, ws_size); grid = -1; return; }
        int dev = 0, cus = 0, per_cu = 0;
        if (hipGetDevice(&dev) != hipSuccess || hipDeviceGetAttribute(&cus, hipDeviceAttributeMultiprocessorCount, dev) != hipSuccess) { grid = -1; return; }
        if (hipFuncSetAttribute((const void*)fwd_megakernel, hipFuncAttributeMaxDynamicSharedMemorySize, LDS_BYTES) != hipSuccess) { fprintf(stderr, "kernel_launch: hipFuncSetAttribute failed\n"); grid = -1; return; }
        if (hipOccupancyMaxActiveBlocksPerMultiprocessor(&per_cu, (const void*)fwd_megakernel, NWAVES * 64, LDS_BYTES) != hipSuccess || per_cu < 1) { per_cu = 1; (void)hipGetLastError(); }
        grid = cus * per_cu;
    }
    if (grid < 0) return;
    Args a{};
    for (int i = 0; i < 14; ++i) a.in[i] = (const float*)d_in[i];
    a.out = (float*)d_out; a.ws = (unsigned char*)d_ws;
    void* kargs[] = {&a};
    const hipError_t e = hipLaunchCooperativeKernel((const void*)fwd_megakernel, dim3(grid), dim3(NWAVES * 64), kargs, LDS_BYTES, stream);
    if (e != hipSuccess) fprintf(stderr, "kernel_launch: cooperative launch failed: %s (grid %d)\n", hipGetErrorString(e), grid);
}
```
